# Optimizing an MI355X kernel written in HIP

```python
import jax, jax.numpy as jnp
from jax import lax
import numpy as np

D_MODEL = 1024
BATCH = 32
SEQ = 2048
DEPTH = 1

N_HEADS = 16
HEAD_DIM = 64
ATTN_WIDTH = N_HEADS * HEAD_DIM
KV_LATENT = 128
IDX_HEADS = 8
IDX_DIM = 64
TOPK_MAX = 256
Q_BLOCK = 128
RNN_WIDTH = 1024
RNN_BLOCKS = 16
RNN_BLOCK_DIM = RNN_WIDTH // RNN_BLOCKS
CONV_WIDTH = 4
LRU_C = 8.0
NORM_EPS = 1e-6
SPLITS = (ATTN_WIDTH, KV_LATENT, IDX_HEADS * IDX_DIM, IDX_DIM, IDX_HEADS, ATTN_WIDTH, RNN_WIDTH, RNN_WIDTH, 2 * D_MODEL)
IN_WIDTH = sum(SPLITS)

kernel_name = 'hybrid_dsa_rglru_gated_block'


def rms_norm(x, g):
    xf = x.astype(jnp.float32)
    y = xf * lax.rsqrt(jnp.mean(xf * xf, axis=-1, keepdims=True) + NORM_EPS)
    return (y * g.astype(jnp.float32)).astype(x.dtype)


def layer_norm(x, g, b):
    xf = x.astype(jnp.float32)
    mu = jnp.mean(xf, axis=-1, keepdims=True)
    xc = xf - mu
    y = xc * lax.rsqrt(jnp.mean(xc * xc, axis=-1, keepdims=True) + NORM_EPS)
    return (y * g.astype(jnp.float32) + b.astype(jnp.float32)).astype(x.dtype)


def alibi_slopes(n):
    return jnp.exp2(-8.0 * jnp.arange(1, n + 1, dtype=jnp.float32) / n)


def split_cols(z):
    offsets = np.cumsum(np.array(SPLITS))[:-1].tolist()
    return jnp.split(z, offsets, axis=-1)


def sparse_mla_attention(q, c_kv, q_idx, k_idx, w_idx, w_uk, w_uv):
    B, S = q.shape[0], q.shape[1]
    topk = min(TOPK_MAX, S // 4)
    tb = min(Q_BLOCK, S)
    nblk = S // tb
    f32 = jnp.float32
    q_lat = jnp.einsum('bshd,hcd->bshc', q, w_uk) * (HEAD_DIM ** -0.5)
    slopes = alibi_slopes(N_HEADS)
    key_pos = jnp.arange(S, dtype=jnp.int32)
    k_idx_f = k_idx.astype(f32)

    def to_blocks(a):
        return a.reshape((B, nblk, tb) + a.shape[2:]).swapaxes(0, 1)

    def block_fn(args):
        ql, qi, wi, t0 = args
        t = t0 + jnp.arange(tb, dtype=jnp.int32)
        s_idx = jax.nn.relu(jnp.einsum('btjd,bsd->btjs', qi.astype(f32), k_idx_f))
        s_idx = jnp.einsum('btjs,btj->bts', s_idx, wi.astype(f32))
        causal = key_pos[None, :] <= t[:, None]
        s_idx = jnp.where(causal[None], s_idx, -jnp.inf)
        _, idx = lax.top_k(s_idx, topk)
        c_sel = jax.vmap(lambda c, i: c[i])(c_kv, idx).astype(f32)
        logits = jnp.einsum('bthc,btkc->bthk', ql.astype(f32), c_sel)
        dist = (t[None, :, None] - idx).astype(f32)
        logits = logits - slopes[None, None, :, None] * dist[:, :, None, :]
        valid = idx <= t[None, :, None]
        logits = jnp.where(valid[:, :, None, :], logits, -jnp.inf)
        p = jax.nn.softmax(logits, axis=-1)
        o = jnp.einsum('bthk,btkc->bthc', p, c_sel)
        return o.astype(ql.dtype)

    t0s = jnp.arange(nblk, dtype=jnp.int32) * tb
    o_lat = lax.map(block_fn, (to_blocks(q_lat), to_blocks(q_idx), to_blocks(w_idx), t0s))
    o_lat = o_lat.swapaxes(0, 1).reshape(B, S, N_HEADS, KV_LATENT)
    return jnp.einsum('bshc,hcd->bshd', o_lat, w_uv)


def causal_depthwise_conv(x, w, b):
    S = x.shape[1]
    xp = jnp.pad(x, ((0, 0), (CONV_WIDTH - 1, 0), (0, 0)))
    out = b
    for k in range(CONV_WIDTH):
        out = out + xp[:, k:k + S] * w[k]
    return out


def rg_lru(x, w_a, b_a, w_x, b_x, lam):
    B, S, C = x.shape
    f32 = jnp.float32
    xb = x.reshape(B, S, RNN_BLOCKS, RNN_BLOCK_DIM)
    r = jax.nn.sigmoid(jnp.einsum('bsgi,gij->bsgj', xb, w_a).reshape(B, S, C) + b_a).astype(f32)
    i = jax.nn.sigmoid(jnp.einsum('bsgi,gij->bsgj', xb, w_x).reshape(B, S, C) + b_x).astype(f32)
    log_a = -LRU_C * r * jax.nn.softplus(-lam.astype(f32))
    a = jnp.exp(log_a)
    b_in = jnp.sqrt(-jnp.expm1(2.0 * log_a)) * (i * x.astype(f32))

    def combine(left, right):
        a1, b1 = left
        a2, b2 = right
        return a1 * a2, a2 * b1 + b2

    _, h = lax.associative_scan(combine, (a, b_in), axis=1)
    return h.astype(x.dtype)


def hybrid_layer(x, norm_g, w_in, b_merge, kv_norm_g, w_uk, w_uv, idx_ln_g, idx_ln_b,
                 w_attn_proj, conv_w, conv_b, w_rg_a, b_rg_a, w_rg_x, b_rg_x, lru_lambda,
                 w_rnn_proj, w_out):
    B, S, _ = x.shape
    xn = rms_norm(x, norm_g)
    z = xn @ w_in
    q, c_kv, q_idx, k_idx, w_idx, g_attn, x_rnn, g_rnn, merge = split_cols(z)
    q = q.reshape(B, S, N_HEADS, HEAD_DIM)
    c_kv = rms_norm(c_kv, kv_norm_g)
    q_idx = q_idx.reshape(B, S, IDX_HEADS, IDX_DIM) * (IDX_DIM ** -0.5)
    k_idx = layer_norm(k_idx, idx_ln_g, idx_ln_b)
    w_idx = w_idx * (IDX_HEADS ** -0.5)
    o = sparse_mla_attention(q, c_kv, q_idx, k_idx, w_idx, w_uk, w_uv).reshape(B, S, ATTN_WIDTH)
    y_attn = (o * jax.nn.silu(g_attn)) @ w_attn_proj
    h = rg_lru(causal_depthwise_conv(x_rnn, conv_w, conv_b), w_rg_a, b_rg_a, w_rg_x, b_rg_x, lru_lambda)
    y_rnn = (h * jax.nn.silu(g_rnn)) @ w_rnn_proj
    gates = jax.nn.sigmoid(merge + b_merge)
    g_a, g_r = gates[..., :D_MODEL], gates[..., D_MODEL:]
    mixed = g_a * y_attn + g_r * y_rnn
    return x + mixed @ w_out


def setup_inputs(seed: int = 0) -> dict:
    key = jax.random.key(seed)
    ks = jax.random.split(key, 24)
    f32 = jnp.float32

    def nrm(k, shape, scale):
        return jax.random.normal(k, shape, f32) * scale

    u = jax.random.uniform(ks[20], (DEPTH, RNN_WIDTH), f32, minval=0.9, maxval=0.999)
    return {
        'x': jax.random.normal(ks[0], (BATCH, SEQ, D_MODEL), f32),
        'norm_gain': 1.0 + nrm(ks[1], (DEPTH, D_MODEL), 0.01),
        'w_in': nrm(ks[2], (DEPTH, D_MODEL, IN_WIDTH), D_MODEL ** -0.5),
        'b_merge': nrm(ks[3], (DEPTH, 2 * D_MODEL), 0.01),
        'kv_norm_gain': 1.0 + nrm(ks[4], (DEPTH, KV_LATENT), 0.01),
        'w_uk': nrm(ks[5], (DEPTH, N_HEADS, KV_LATENT, HEAD_DIM), KV_LATENT ** -0.5),
        'w_uv': nrm(ks[6], (DEPTH, N_HEADS, KV_LATENT, HEAD_DIM), KV_LATENT ** -0.5),
        'idx_ln_gain': 1.0 + nrm(ks[7], (DEPTH, IDX_DIM), 0.01),
        'idx_ln_bias': nrm(ks[8], (DEPTH, IDX_DIM), 0.01),
        'w_attn_proj': nrm(ks[9], (DEPTH, ATTN_WIDTH, D_MODEL), ATTN_WIDTH ** -0.5),
        'conv_w': nrm(ks[10], (DEPTH, CONV_WIDTH, RNN_WIDTH), CONV_WIDTH ** -0.5),
        'conv_b': nrm(ks[11], (DEPTH, RNN_WIDTH), 0.01),
        'w_rg_a': nrm(ks[12], (DEPTH, RNN_BLOCKS, RNN_BLOCK_DIM, RNN_BLOCK_DIM), RNN_BLOCK_DIM ** -0.5),
        'b_rg_a': nrm(ks[13], (DEPTH, RNN_WIDTH), 0.01),
        'w_rg_x': nrm(ks[14], (DEPTH, RNN_BLOCKS, RNN_BLOCK_DIM, RNN_BLOCK_DIM), RNN_BLOCK_DIM ** -0.5),
        'b_rg_x': nrm(ks[15], (DEPTH, RNN_WIDTH), 0.01),
        'lru_lambda': jnp.log(u) - jnp.log1p(-u),
        'w_rnn_proj': nrm(ks[16], (DEPTH, RNN_WIDTH, D_MODEL), RNN_WIDTH ** -0.5),
        'w_out': nrm(ks[17], (DEPTH, D_MODEL, D_MODEL), D_MODEL ** -0.5),
        'final_norm_gain': 1.0 + nrm(ks[18], (D_MODEL,), 0.01),
    }


def reference(x, norm_gain, w_in, b_merge, kv_norm_gain, w_uk, w_uv, idx_ln_gain, idx_ln_bias,
              w_attn_proj, conv_w, conv_b, w_rg_a, b_rg_a, w_rg_x, b_rg_x, lru_lambda,
              w_rnn_proj, w_out, final_norm_gain):
    for l in range(DEPTH):
        x = hybrid_layer(x, norm_gain[l], w_in[l], b_merge[l], kv_norm_gain[l], w_uk[l], w_uv[l],
                         idx_ln_gain[l], idx_ln_bias[l], w_attn_proj[l], conv_w[l], conv_b[l],
                         w_rg_a[l], b_rg_a[l], w_rg_x[l], b_rg_x[l], lru_lambda[l],
                         w_rnn_proj[l], w_out[l])
    return rms_norm(x, final_norm_gain)
```

```cpp
#include <hip/hip_runtime.h>
#include <cstdio>
#include <cstdint>
namespace pg8 {
#define PG8_LAS __attribute__((address_space(3)))
typedef unsigned short bf16_t;
typedef short bf16x8 __attribute__((ext_vector_type(8)));
typedef float f32x4 __attribute__((ext_vector_type(4)));
typedef unsigned u32x4 __attribute__((ext_vector_type(4)));
constexpr int BM = 256, BK = 64, HALF = 128, HTB = HALF * BK * 2  , STAGE_BYTES = 8 * HTB, NXCD = 8, WGM = 8;

__host__ __device__ __forceinline__ int lds_byte(int r, int c) { const int st = (r >> 4) * 2 + (c >> 5), rr = r & 15, cc = c & 31, ob = rr * 64 + cc * 2; return st * 1024 + (ob ^ (((ob >> 9) & 1) << 5)); }
__host__ __device__ __forceinline__ void stage_rc(int b, int& R, int& C) { const int st = b / 1024, sb = b % 1024, swz = sb ^ (((sb >> 9) & 1) << 5); R = (st >> 1) * 16 + swz / 64; C = (st & 1) * 32 + (swz % 64) / 2; }
__host__ __device__ __forceinline__ int perm32(int rho) { const int n = rho >> 4, i = rho & 15; return 8 * (i >> 2) + 4 * n + (i & 3); }

struct Unit { int pm, pn; };
struct Gemm { const bf16_t* A; const bf16_t* Bt; int M, N, K; };

struct StaticOrder {
    int nM, nN, nwg, G, c;
    __host__ __device__ void init(int M, int N, int G_, int c_) { nM = M / BM; nN = N / BM; nwg = nM * nN; G = G_; c = c_; }
    __host__ __device__ bool next(int i, Unit& u) const {
        const long L = (long)i * G + c; if (L >= nwg) return false;
        int wgid = (int)L; { const int q = nwg / NXCD, r = nwg % NXCD, xcd = wgid % NXCD, off = wgid / NXCD; wgid = (xcd < r ? xcd * (q + 1) : r * (q + 1) + (xcd - r) * q) + off; }
        const int nig = WGM * nN, gid = wgid / nig, fm = gid * WGM, gsz = (nM - fm) < WGM ? (nM - fm) : WGM;
        u.pm = fm + ((wgid % nig) % gsz); u.pn = (wgid % nig) / gsz; return true;
    }
    __device__ __forceinline__ void a_ready(const Unit&) const {}
    __device__ __forceinline__ void done(const Unit&) const {}
};

typedef float f32x2_t __attribute__((ext_vector_type(2))); typedef __bf16 bf16x2_t __attribute__((ext_vector_type(2)));
__device__ __forceinline__ unsigned cvt_pk_bf16(float lo, float hi) { f32x2_t v = {lo, hi}; bf16x2_t b = __builtin_convertvector(v, bf16x2_t); return __builtin_bit_cast(unsigned, b); }
__device__ __forceinline__ float sigmoidf_fast(float x) { return __builtin_amdgcn_rcpf(1.0f + __builtin_amdgcn_exp2f(x * -1.4426950408889634f)); }
__device__ __forceinline__ f32x4 sig4(f32x4 v) { return (f32x4){sigmoidf_fast(v[0]), sigmoidf_fast(v[1]), sigmoidf_fast(v[2]), sigmoidf_fast(v[3])}; }
__device__ __forceinline__ u32x4 pack8(f32x4 v0, f32x4 v1) { u32x4 w; w.x = cvt_pk_bf16(v0[0], v0[1]); w.y = cvt_pk_bf16(v0[2], v0[3]); w.z = cvt_pk_bf16(v1[0], v1[1]); w.w = cvt_pk_bf16(v1[2], v1[3]); return w; }
__device__ __forceinline__ f32x4 unpk_lo(unsigned a, unsigned b) { return (f32x4){__uint_as_float(a << 16), __uint_as_float(a & 0xffff0000u), __uint_as_float(b << 16), __uint_as_float(b & 0xffff0000u)}; }

struct EpiIn {
    static constexpr bool PERM = true, AFTER_DRAIN = false;
    const float* rstd; const float* bmerge; bf16_t *Q, *QIDX, *GATTN, *XRNN, *GRNN, *GATES; float* T4;
    __device__ __forceinline__ void operator()(const f32x4 (&acc)[2][2][4][2], const Unit& u, int wr, int wc, int fr, int fq) const {
        const int pn = u.pn, row0 = u.pm * BM + wr * 64 + fr, cl = wc * 32 + 8 * fq;
        float rsv[2][4];
#pragma unroll
        for (int ai = 0; ai < 2; ++ai)
#pragma unroll
            for (int m = 0; m < 4; ++m) rsv[ai][m] = rstd[row0 + ai * HALF + m * 16];
        if (pn == 4) {
#pragma unroll
            for (int ai = 0; ai < 2; ++ai)
#pragma unroll
                for (int m = 0; m < 4; ++m) { const int row = row0 + ai * HALF + m * 16; const float rs = rsv[ai][m]; float* p = T4 + (size_t)row * 256 + cl;
#pragma unroll
                    for (int bj = 0; bj < 2; ++bj) { *(f32x4*)(p + bj * HALF) = acc[ai][bj][m][0] * rs; *(f32x4*)(p + bj * HALF + 4) = acc[ai][bj][m][1] * rs; } }
            return;
        }
        int mode, ld, c0; bf16_t* base; float sc = 1.f;
        if (pn < 4)       { mode = 0; base = Q;     ld = 1024; c0 = pn * 256; }
        else if (pn < 7)  { mode = 0; base = QIDX;  ld = 512;  c0 = (pn - 5) * 256; sc = 0.125f; }
        else if (pn < 11) { mode = 1; base = GATTN; ld = 1024; c0 = (pn - 7) * 256; }
        else if (pn < 15) { mode = 0; base = XRNN;  ld = 1024; c0 = (pn - 11) * 256; }
        else if (pn < 19) { mode = 1; base = GRNN;  ld = 1024; c0 = (pn - 15) * 256; }
        else              { mode = 2; base = GATES; ld = 2048; c0 = (pn - 19) * 256; }
        f32x4 bv[2][2];
#pragma unroll
        for (int bj = 0; bj < 2; ++bj)
#pragma unroll
            for (int n = 0; n < 2; ++n) bv[bj][n] = (mode == 2) ? *(const f32x4*)(bmerge + c0 + cl + bj * HALF + 4 * n) : (f32x4){0.f, 0.f, 0.f, 0.f};
#pragma unroll
        for (int ai = 0; ai < 2; ++ai)
#pragma unroll
            for (int m = 0; m < 4; ++m) { const int row = row0 + ai * HALF + m * 16; const float rs = rsv[ai][m] * sc; bf16_t* rowp = base + (size_t)row * ld + c0 + cl;
#pragma unroll
                for (int bj = 0; bj < 2; ++bj) { f32x4 v0 = acc[ai][bj][m][0] * rs + bv[bj][0], v1 = acc[ai][bj][m][1] * rs + bv[bj][1];
                    if (mode == 1) { v0 = v0 * sig4(v0); v1 = v1 * sig4(v1); }
                    else if (mode == 2) { v0 = sig4(v0); v1 = sig4(v1); }
                    *(u32x4*)(rowp + bj * HALF) = pack8(v0, v1); } }
    }
};
struct EpiMx {
    static constexpr bool PERM = true, AFTER_DRAIN = false;
    const bf16_t* GATES; bf16_t* MX;
    __device__ __forceinline__ void operator()(const f32x4 (&acc)[2][2][4][2], const Unit& u, int wr, int wc, int fr, int fq) const {
        const int row0 = u.pm * BM + wr * 64 + fr, col0 = u.pn * BM + wc * 32 + 8 * fq;
#pragma unroll
        for (int ai = 0; ai < 2; ++ai) { u32x4 gq[4][2];
#pragma unroll
            for (int m = 0; m < 4; ++m)
#pragma unroll
                for (int bj = 0; bj < 2; ++bj) gq[m][bj] = *(const u32x4*)(GATES + (size_t)(row0 + ai * HALF + m * 16) * 2048 + 1024 + col0 + bj * HALF);
#pragma unroll
            for (int m = 0; m < 4; ++m) { const int row = row0 + ai * HALF + m * 16;
#pragma unroll
                for (int bj = 0; bj < 2; ++bj) { const u32x4 g = gq[m][bj];
                    const f32x4 v0 = acc[ai][bj][m][0] * unpk_lo(g.x, g.y), v1 = acc[ai][bj][m][1] * unpk_lo(g.z, g.w);
                    *(u32x4*)(MX + (size_t)row * 1024 + col0 + bj * HALF) = pack8(v0, v1); } } }
    }
};
struct EpiMixed {
    static constexpr bool PERM = true, AFTER_DRAIN = false;
    const bf16_t* GATES; const bf16_t* MX; bf16_t* MIXED;
    __device__ __forceinline__ void operator()(const f32x4 (&acc)[2][2][4][2], const Unit& u, int wr, int wc, int fr, int fq) const {
        const int row0 = u.pm * BM + wr * 64 + fr, col0 = u.pn * BM + wc * 32 + 8 * fq;
#pragma unroll
        for (int ai = 0; ai < 2; ++ai) { u32x4 gq[4][2], xq[4][2];
#pragma unroll
            for (int m = 0; m < 4; ++m)
#pragma unroll
                for (int bj = 0; bj < 2; ++bj) { gq[m][bj] = *(const u32x4*)(GATES + (size_t)(row0 + ai * HALF + m * 16) * 2048 + col0 + bj * HALF); xq[m][bj] = *(const u32x4*)(MX + (size_t)(row0 + ai * HALF + m * 16) * 1024 + col0 + bj * HALF); }
#pragma unroll
            for (int m = 0; m < 4; ++m) { const int row = row0 + ai * HALF + m * 16;
#pragma unroll
                for (int bj = 0; bj < 2; ++bj) { const u32x4 g = gq[m][bj]; const u32x4 x = xq[m][bj];
                    const f32x4 v0 = acc[ai][bj][m][0] * unpk_lo(g.x, g.y) + unpk_lo(x.x, x.y), v1 = acc[ai][bj][m][1] * unpk_lo(g.z, g.w) + unpk_lo(x.z, x.w);
                    *(u32x4*)(MIXED + (size_t)row * 1024 + col0 + bj * HALF) = pack8(v0, v1); } } }
    }
};
struct EpiOut {
    static constexpr bool PERM = false, AFTER_DRAIN = false;
    const float* X; float* Y; float* rowss;
    __device__ __forceinline__ void operator()(const f32x4 (&acc)[2][2][4][2], const Unit& u, int wr, int wc, int fr, int fq) const {
        const int row0 = u.pm * BM + wr * 64 + fr, col0 = u.pn * BM + wc * 32 + 4 * fq;
#pragma unroll
        for (int ai = 0; ai < 2; ++ai) { f32x4 xq[4][2][2];
#pragma unroll
            for (int m = 0; m < 4; ++m)
#pragma unroll
                for (int bj = 0; bj < 2; ++bj)
#pragma unroll
                    for (int n = 0; n < 2; ++n) xq[m][bj][n] = *(const f32x4*)(X + (size_t)(row0 + ai * HALF + m * 16) * 1024 + col0 + bj * HALF + n * 16);
#pragma unroll
            for (int m = 0; m < 4; ++m) { const int row = row0 + ai * HALF + m * 16; const size_t off = (size_t)row * 1024 + col0; float ss = 0.f;
#pragma unroll
                for (int bj = 0; bj < 2; ++bj)
#pragma unroll
                    for (int n = 0; n < 2; ++n) { const f32x4 y = xq[m][bj][n] + acc[ai][bj][m][n]; *(f32x4*)(Y + off + bj * HALF + n * 16) = y;
                        ss += (y[0] * y[0] + y[1] * y[1]) + (y[2] * y[2] + y[3] * y[3]); }
                ss += __shfl_xor(ss, 16); ss += __shfl_xor(ss, 32);
                if (fq == 0) atomicAdd(rowss + row, ss); } }
    }
};
template <class Epi, class Sched, bool ALIGN_EPI = false, bool SP2 = false>
__device__ __forceinline__ void gemm_phase(PG8_LAS unsigned char* lds, const Gemm g, const Sched& S, const Epi& E) {
    const int tid = threadIdx.x, wid = __builtin_amdgcn_readfirstlane(tid >> 6), lane = tid & 63, wr = wid >> 2, wc = wid & 3, fr = lane & 15, fq = lane >> 4;
    const int K = g.K, nt = K / BK;
    unsigned voffA[2], voffB[2];
#pragma unroll
    for (int i = 0; i < 2; ++i) { int R, C; stage_rc(tid * 16 + i * 8192, R, C); const int Rb = Epi::PERM ? ((R & ~31) + perm32(R & 31)) : R;
        voffA[i] = (unsigned)(R * K + C) * 2u; voffB[i] = (unsigned)(Rb * K + C) * 2u; }
    const size_t kstep = (size_t)(BK * 2);
    const size_t hstep = (size_t)HALF * K * 2;
    const size_t tstep = 2 * hstep;
    const unsigned ldsw = (unsigned)wid * 1024u;
    const int aoff = lds_byte(wr * 64 + fr, fq * 8), boff = lds_byte(wc * 32 + fr, fq * 8);
#define PG8_SA(b, h) (((b) * 2 + (h)) * HTB)
#define PG8_SB(b, h) ((4 + (b) * 2 + (h)) * HTB)
#define PG8_STAGE(bufoff, gbase, voff) do { _Pragma("unroll") for (int _i = 0; _i < 2; ++_i) \
        __builtin_amdgcn_global_load_lds((const unsigned*)((const char*)(gbase) + (voff)[_i]), (PG8_LAS unsigned*)(lds + (bufoff) + ldsw + _i * 8192), 16, 0, 0); } while (0)
#define PG8_LDA(dst, b, h) do { _Pragma("unroll") for (int m = 0; m < 4; ++m) _Pragma("unroll") for (int k = 0; k < 2; ++k) dst[m][k] = *(const PG8_LAS bf16x8*)(lds + PG8_SA(b, h) + aoff + m * 2048 + k * 1024); } while (0)
#define PG8_LDB(dst, b, h) do { _Pragma("unroll") for (int n = 0; n < 2; ++n) _Pragma("unroll") for (int k = 0; k < 2; ++k) dst[n][k] = *(const PG8_LAS bf16x8*)(lds + PG8_SB(b, h) + boff + n * 2048 + k * 1024); } while (0)
#define PG8_MMA(ai, bj, At, Bt) do { __builtin_amdgcn_s_setprio(1); _Pragma("unroll") for (int m = 0; m < 4; ++m) _Pragma("unroll") for (int n = 0; n < 2; ++n) _Pragma("unroll") for (int k = 0; k < 2; ++k) \
        acc[ai][bj][m][n] = __builtin_amdgcn_mfma_f32_16x16x32_bf16(Bt[n][k], At[m][k], acc[ai][bj][m][n], 0, 0, 0); __builtin_amdgcn_s_setprio(0); } while (0)
#define PG8_WAIT_V(n) asm volatile("s_waitcnt vmcnt(" #n ")" ::: "memory")
#define PG8_WAIT_L(n) asm volatile("s_waitcnt lgkmcnt(" #n ")" ::: "memory")
#define PG8_BAR __builtin_amdgcn_s_barrier()
#define PG8_SCHED __builtin_amdgcn_sched_barrier(0)
    Unit cur, nxt; int ui = 0;
    if (!S.next(0, cur)) return;
    f32x4 acc[2][2][4][2];
#pragma unroll
    for (int a = 0; a < 2; ++a)
#pragma unroll
        for (int b = 0; b < 2; ++b)
#pragma unroll
            for (int m = 0; m < 4; ++m)
#pragma unroll
                for (int n = 0; n < 2; ++n) acc[a][b][m][n] = (f32x4){0.f, 0.f, 0.f, 0.f};
    bf16x8 At[4][2], B0[2][2], B1[2][2];
    const char* cA = (const char*)g.A + (size_t)cur.pm * tstep; const char* cB = (const char*)g.Bt + (size_t)cur.pn * tstep;
    S.a_ready(cur);
    if constexpr (SP2) {
        PG8_STAGE(PG8_SB(0, 0), cB, voffB); PG8_STAGE(PG8_SB(0, 1), cB + hstep, voffB); PG8_STAGE(PG8_SA(0, 0), cA, voffA); PG8_STAGE(PG8_SA(0, 1), cA + hstep, voffA);
        if (wr == 1) PG8_BAR;
        PG8_WAIT_V(2); PG8_BAR;
        PG8_STAGE(PG8_SB(1, 0), cB + kstep, voffB); PG8_STAGE(PG8_SA(1, 0), cA + kstep, voffA); PG8_STAGE(PG8_SB(1, 1), cB + hstep + kstep, voffB);
        PG8_WAIT_V(6); PG8_BAR;
    } else {
        PG8_STAGE(PG8_SB(0, 0), cB, voffB); PG8_STAGE(PG8_SA(0, 0), cA, voffA); PG8_STAGE(PG8_SB(0, 1), cB + hstep, voffB); PG8_STAGE(PG8_SA(0, 1), cA + hstep, voffA);
        if (wr == 1) PG8_BAR;
        PG8_WAIT_V(4); PG8_BAR;
        PG8_STAGE(PG8_SB(1, 0), cB + kstep, voffB); PG8_STAGE(PG8_SA(1, 0), cA + kstep, voffA); PG8_STAGE(PG8_SB(1, 1), cB + hstep + kstep, voffB);
        PG8_WAIT_V(6); PG8_BAR;
    }
    for (;;) {
        const bool has_next = S.next(ui + 1, nxt);
        const char* nA = has_next ? (const char*)g.A + (size_t)nxt.pm * tstep : cA; const char* nB = has_next ? (const char*)g.Bt + (size_t)nxt.pn * tstep : cB;
        for (int t = 0; t < nt; t += 2) {
            const bool last = (t == nt - 2);
            const char* a1 = cA + (size_t)(t + 1) * kstep;
            const char* a2 = last ? nA : cA + (size_t)(t + 2) * kstep; const char* b2 = last ? nB : cB + (size_t)(t + 2) * kstep;
            const char* a3 = a2 + kstep; const char* b3 = b2 + kstep;
            if (last && has_next) S.a_ready(nxt);
            if constexpr (SP2) {
            PG8_LDB(B0, 0, 0); PG8_LDB(B1, 0, 1); PG8_SCHED; PG8_LDA(At, 0, 0); PG8_STAGE(PG8_SA(1, 1), a1 + hstep, voffA);
            PG8_WAIT_V(8); PG8_WAIT_L(0); PG8_BAR; PG8_MMA(0, 0, At, B0); PG8_MMA(0, 1, At, B1); PG8_BAR; PG8_SCHED;
            PG8_LDA(At, 0, 1); PG8_STAGE(PG8_SB(0, 0), b2, voffB); PG8_STAGE(PG8_SB(0, 1), b2 + hstep, voffB); PG8_STAGE(PG8_SA(0, 0), a2, voffA);
            PG8_WAIT_V(8); PG8_WAIT_L(0); PG8_BAR; PG8_MMA(1, 0, At, B0); PG8_MMA(1, 1, At, B1); PG8_BAR; PG8_SCHED;
            PG8_LDB(B0, 1, 0); PG8_LDB(B1, 1, 1); PG8_SCHED; PG8_LDA(At, 1, 0); PG8_STAGE(PG8_SA(0, 1), a2 + hstep, voffA);
            PG8_WAIT_V(8); PG8_WAIT_L(0); PG8_BAR; PG8_MMA(0, 0, At, B0); PG8_MMA(0, 1, At, B1); PG8_BAR; PG8_SCHED;
            PG8_LDA(At, 1, 1); PG8_STAGE(PG8_SB(1, 0), b3, voffB); PG8_STAGE(PG8_SB(1, 1), b3 + hstep, voffB); PG8_STAGE(PG8_SA(1, 0), a3, voffA);
            PG8_WAIT_V(8); PG8_WAIT_L(0); PG8_BAR; PG8_MMA(1, 0, At, B0); PG8_MMA(1, 1, At, B1); PG8_BAR; PG8_SCHED;
            } else {
            PG8_LDB(B0, 0, 0); PG8_SCHED; PG8_LDA(At, 0, 0); PG8_STAGE(PG8_SA(1, 1), a1 + hstep, voffA);
            PG8_WAIT_L(8); PG8_BAR; PG8_WAIT_L(0); PG8_MMA(0, 0, At, B0); PG8_BAR; PG8_SCHED;
            PG8_LDB(B1, 0, 1); PG8_STAGE(PG8_SB(0, 0), b2, voffB);
            PG8_BAR; PG8_WAIT_L(0); PG8_MMA(0, 1, At, B1); PG8_BAR;
            PG8_LDA(At, 0, 1); PG8_STAGE(PG8_SA(0, 0), a2, voffA);
            PG8_BAR; PG8_WAIT_L(0); PG8_MMA(1, 0, At, B0); PG8_BAR; PG8_SCHED;
            PG8_STAGE(PG8_SB(0, 1), b2 + hstep, voffB);
            PG8_WAIT_V(6); PG8_BAR; PG8_MMA(1, 1, At, B1); PG8_BAR;
            PG8_LDB(B0, 1, 0); PG8_SCHED; PG8_LDA(At, 1, 0); PG8_STAGE(PG8_SA(0, 1), a2 + hstep, voffA);
            PG8_WAIT_L(8); PG8_BAR; PG8_WAIT_L(0); PG8_MMA(0, 0, At, B0); PG8_BAR; PG8_SCHED;
            PG8_LDB(B1, 1, 1); PG8_STAGE(PG8_SB(1, 0), b3, voffB);
            PG8_BAR; PG8_WAIT_L(0); PG8_MMA(0, 1, At, B1); PG8_BAR;
            PG8_LDA(At, 1, 1); PG8_STAGE(PG8_SA(1, 0), a3, voffA);
            PG8_BAR; PG8_WAIT_L(0); PG8_MMA(1, 0, At, B0); PG8_BAR; PG8_SCHED;
            PG8_STAGE(PG8_SB(1, 1), b3 + hstep, voffB);
            PG8_WAIT_V(6); PG8_BAR; PG8_MMA(1, 1, At, B1); PG8_BAR;
            }
        }
        if constexpr (ALIGN_EPI) { if (wr == 0) PG8_BAR; }
        if constexpr (!Epi::AFTER_DRAIN) { E(acc, cur, wr, wc, fr, fq); S.done(cur); }
        if (!has_next) break;
#pragma unroll
        for (int a = 0; a < 2; ++a)
#pragma unroll
            for (int b = 0; b < 2; ++b)
#pragma unroll
                for (int m = 0; m < 4; ++m)
#pragma unroll
                    for (int n = 0; n < 2; ++n) acc[a][b][m][n] = (f32x4){0.f, 0.f, 0.f, 0.f};
        cur = nxt; cA = nA; cB = nB; ++ui;
        if constexpr (ALIGN_EPI) { if (wr == 1) PG8_BAR; }
    }
    PG8_WAIT_V(0);
    if constexpr (!ALIGN_EPI) { if (wr == 0) PG8_BAR; }
    PG8_BAR;
    if constexpr (Epi::AFTER_DRAIN) { E.fused(acc, cur, wr, wc, fr, fq, lds, wid, lane); S.done(cur); }
#undef PG8_SA
#undef PG8_SB
#undef PG8_STAGE
#undef PG8_LDA
#undef PG8_LDB
#undef PG8_MMA
#undef PG8_WAIT_V
#undef PG8_WAIT_L
#undef PG8_BAR
#undef PG8_SCHED
}
}
constexpr int NWAVES = 8;
#ifndef MK_N_LAUNCHES
#define MK_N_LAUNCHES 1
#endif
constexpr int N_PHASES = 7;
constexpr int N_LAUNCHES = MK_N_LAUNCHES;

constexpr int BATCH = 32, SEQ = 2048, D = 1024, M = BATCH * SEQ;
constexpr int NH = 16, HD = 64, DC = 128, IH = 8, ID = 64, TOPK = 256;
constexpr int IN_W = 6856, NPAD = 6912;
constexpr float EPS = 1e-6f;
constexpr float LOG2E = 1.4426950408889634f;

constexpr size_t MiB = 1u << 20;
constexpr size_t WS_CTL = 0, CTL_ZERO_BYTES = 1 * MiB;
constexpr size_t WS_RSTD = 1 * MiB, WS_ROWSS = WS_RSTD + 256 * 1024, WS_WIDX = WS_ROWSS + 256 * 1024;
constexpr size_t WS_WTIN = 4 * MiB;
constexpr size_t WS_WTATTN = 18 * MiB, WS_WTRNN = 20 * MiB, WS_WTOUT = 22 * MiB;
constexpr size_t WS_WUK = 24 * MiB, WS_WUVT = WS_WUK + 256 * 1024;
constexpr size_t WS_CKV = 25 * MiB;
constexpr size_t WS_KIDX = 41 * MiB;
constexpr size_t WS_T4 = 64 * MiB;
constexpr size_t WS_Q = 128 * MiB;
constexpr size_t WS_QIDX = 256 * MiB;
constexpr size_t WS_GATTN = 320 * MiB;
constexpr size_t WS_XRNN = 448 * MiB;
constexpr size_t WS_GRNN = 576 * MiB;
constexpr size_t WS_GATES = 704 * MiB;
constexpr size_t WS_END = 960 * MiB;
constexpr int CW_TMO = 0, CW_CODE = 1, CW_BAR = 4096;

constexpr int RING_OFF = 0, RING_BYTES = 131072;
constexpr int SC_STRIDE = 2052;
constexpr int L_SC = 0;
constexpr int L_QL = 0, L_GB = 65536;
constexpr int L_SEL = 132096;
constexpr int L_HIST = 140288;
constexpr int L_FRAG = 0;
constexpr int LDSCTL_OFF = 148480, MISC_OFF = LDSCTL_OFF + 320;
constexpr int LDS_BYTES = 151552;
static_assert(MISC_OFF + 128 <= LDS_BYTES && L_SC + 16 * SC_STRIDE * 4 <= L_SEL && L_SEL + 8192 <= L_HIST && L_HIST + 8192 <= LDSCTL_OFF, "LDS map");

#define GAS __attribute__((address_space(1)))
#define LAS __attribute__((address_space(3)))
typedef unsigned short bf16;
typedef unsigned v4u __attribute__((ext_vector_type(4)));
typedef unsigned v2u __attribute__((ext_vector_type(2)));
typedef float f32x4 __attribute__((ext_vector_type(4)));
typedef float f32x16 __attribute__((ext_vector_type(16)));
typedef short bf16x8 __attribute__((ext_vector_type(8)));
typedef short s16x4 __attribute__((ext_vector_type(4)));
typedef GAS unsigned gu32;
#define RLX_AGENT __ATOMIC_RELAXED, __HIP_MEMORY_SCOPE_AGENT
#define LDS_WAIT() asm volatile("s_waitcnt lgkmcnt(0)" ::: "memory")
#define VM_WAIT() asm volatile("s_waitcnt vmcnt(0)" ::: "memory")
__device__ __forceinline__ unsigned f2bf(float f) { unsigned u = __builtin_bit_cast(unsigned, f); return (u + 0x7fffu + ((u >> 16) & 1u)) >> 16; }
__device__ __forceinline__ unsigned pk2(float lo, float hi) { return f2bf(lo) | (f2bf(hi) << 16); }
__device__ __forceinline__ float bf_lo(unsigned u) { return __uint_as_float(u << 16); }
__device__ __forceinline__ float bf_hi(unsigned u) { return __uint_as_float(u & 0xffff0000u); }
__device__ __forceinline__ float ex2(float x) { return __builtin_amdgcn_exp2f(x); }
__device__ __forceinline__ float sigm(float x) { return __builtin_amdgcn_rcpf(1.0f + ex2(x * -LOG2E)); }
__device__ __forceinline__ bf16x8 as_bf16x8(v4u v) { return __builtin_bit_cast(bf16x8, v); }
#define XB_TMO      128
#define XB_XCNT(j)  (256  + 64 * (j))
#define XB_XSUB(j)  (1280 + 64 * (j))
#define XB_XGEN(j)  (2304 + 64 * (j))
#define XB_TOP      3328
#define XB_TOPGEN   3392
#define XCD_BAR_WORDS 3456
#define XB_SPIN_CAP (1u << 18)

__device__ __forceinline__ unsigned xb_ld(unsigned* p)              { return __hip_atomic_load(p, __ATOMIC_RELAXED, __HIP_MEMORY_SCOPE_AGENT); }
__device__ __forceinline__ unsigned xb_add(unsigned* p, unsigned v) { return __hip_atomic_fetch_add(p, v, __ATOMIC_RELAXED, __HIP_MEMORY_SCOPE_AGENT); }
__device__ __forceinline__ unsigned xb_xcc_id() { return (unsigned)__builtin_amdgcn_s_getreg((3 << 11) | 20) & 0xFu; }
#define XB_SPIN(cond, bar) do { unsigned _sp = 0; while (cond) { __builtin_amdgcn_s_sleep(1); \
    if ((++_sp & 255u) == 0u) { if (xb_ld(&(bar)[XB_TMO])) break; if (_sp > XB_SPIN_CAP) { atomicAdd(&(bar)[XB_TMO], 1u); break; } } } } while (0)

struct XcdBarrier {
    unsigned* bar; unsigned x;
    volatile LAS unsigned* st;
};

__device__ __forceinline__ XcdBarrier xcd_barrier_post(unsigned* bar, volatile LAS unsigned* st) {
    XcdBarrier b; b.bar = bar; b.x = xb_xcc_id(); b.st = st;
    if (threadIdx.x == 0) (void)xb_add(&bar[XB_XCNT(b.x)], 1u);
    return b;
}
__device__ __forceinline__ void xcd_barrier_complete(unsigned* bar, unsigned x, unsigned& nloc, unsigned& nx) {
    const unsigned G = gridDim.x * gridDim.y * gridDim.z;
    unsigned sum, cnt, mine, sp = 0u;
    for (;;) {
        sum = 0u; cnt = 0u; mine = 0u;
#pragma unroll
        for (unsigned j = 0; j < 16; ++j) { const unsigned c = xb_ld(&bar[XB_XCNT(j)]); sum += c; cnt += (c > 0u) ? 1u : 0u; mine = (j == x) ? c : mine; }
        if (sum == G) break;
        __builtin_amdgcn_s_sleep(1);
        if ((++sp & 255u) == 0u) { if (xb_ld(&bar[XB_TMO])) break; if (sp > XB_SPIN_CAP) { atomicAdd(&bar[XB_TMO], 1u); break; } }
    }
    nloc = mine > 0u ? mine : 1u; nx = cnt > 0u ? cnt : 1u;
}

__device__ __forceinline__ void xcd_barrier(const XcdBarrier& b) {
    asm volatile("s_waitcnt vmcnt(0)" ::: "memory");
    __syncthreads();
    if (threadIdx.x == 0) {
        unsigned* bar = b.bar;
        __builtin_amdgcn_s_waitcnt(0);
        unsigned nloc = b.st[0], nx = b.st[1];
        if (nloc == 0u) { xcd_barrier_complete(bar, b.x, nloc, nx); b.st[0] = nloc; b.st[1] = nx; }
        const unsigned old = xb_add(&bar[XB_XSUB(b.x)], 1u);
        const unsigned gen = old / nloc;
        if (old + 1u == (gen + 1u) * nloc) {
            __builtin_amdgcn_fence(__ATOMIC_RELEASE, "agent");
            asm volatile("s_waitcnt vmcnt(0)" ::: "memory");
            const unsigned og = xb_add(&bar[XB_TOP], 1u);
            const unsigned tg = og / nx;
            if (og + 1u == (tg + 1u) * nx) xb_add(&bar[XB_TOPGEN], 1u);
            else XB_SPIN(xb_ld(&bar[XB_TOPGEN]) == tg, bar);
            __builtin_amdgcn_fence(__ATOMIC_ACQUIRE, "agent");
            xb_add(&bar[XB_XGEN(b.x)], 1u);
            asm volatile("s_waitcnt vmcnt(0)" ::: "memory");
        } else {
            XB_SPIN(xb_ld(&bar[XB_XGEN(b.x)]) == gen, bar);
            __builtin_amdgcn_fence(__ATOMIC_ACQUIRE, "agent");
            asm volatile("s_waitcnt vmcnt(0)" ::: "memory");
        }
    }
    __syncthreads();
}
__device__ __forceinline__ float wave_sum(float v) {
#pragma unroll
    for (int o = 1; o < 64; o <<= 1) v += __shfl_xor(v, o);
    return v;
}
__device__ __forceinline__ float wave_max(float v) {
#pragma unroll
    for (int o = 1; o < 64; o <<= 1) v = fmaxf(v, __shfl_xor(v, o));
    return v;
}
__device__ __forceinline__ f32x4 mfma16(bf16x8 a, bf16x8 b, f32x4 c) { return __builtin_amdgcn_mfma_f32_16x16x32_bf16(a, b, c, 0, 0, 0); }
__device__ __forceinline__ f32x16 mfma32(bf16x8 a, bf16x8 b, f32x16 c) { return __builtin_amdgcn_mfma_f32_32x32x16_bf16(a, b, c, 0, 0, 0); }
typedef float f32x2_t __attribute__((ext_vector_type(2))); typedef __bf16 bf16x2_t __attribute__((ext_vector_type(2)));
__device__ __forceinline__ unsigned cvtpk(float lo, float hi) { f32x2_t v = {lo, hi}; bf16x2_t b = __builtin_convertvector(v, bf16x2_t); return __builtin_bit_cast(unsigned, b); }
typedef short v4i16_t __attribute__((ext_vector_type(4)));
__device__ __forceinline__ s16x4 tr_read(LAS unsigned char* p) { return __builtin_bit_cast(s16x4, __builtin_amdgcn_ds_read_tr16_b64_v4i16((LAS v4i16_t*)p)); }

__device__ __forceinline__ int in_src_col(int np) {
    if (np < 1152) return np;
    if (np < 1216) return 1664 + (np - 1152);
    if (np < 1224) return 1728 + (np - 1216);
    if (np < 1280) return -1;
    if (np < 1792) return 1152 + (np - 1280);
    return 1736 + (np - 1792);
}
template <bool IN>
__device__ __forceinline__ void p0_transpose_item(const float* W, int K, int N, const float* gain, bf16* WT, LAS float* scr, int item, int nblk, int lane) {
    const int kb = item / nblk, nb = item % nblk, k0 = 64 * kb, n0 = 32 * nb;
    const int nd = n0 + (lane & 31); const int ns = IN ? in_src_col(nd) : nd;
#pragma unroll 8
    for (int i = 0; i < 32; ++i) { const int kk = 2 * i + (lane >> 5); float v = 0.f; if (ns >= 0) v = W[(size_t)(k0 + kk) * N + ns]; if (IN) v *= gain[k0 + kk]; scr[kk * 33 + (lane & 31)] = v; }
    LDS_WAIT(); asm volatile("" ::: "memory");
    const int c = lane & 7;
#pragma unroll
    for (int j = 0; j < 4; ++j) { const int n = (lane >> 3) + 8 * j; const LAS float* s = scr + (8 * c) * 33 + n;
        v4u o; o.x = pk2(s[0 * 33], s[1 * 33]); o.y = pk2(s[2 * 33], s[3 * 33]); o.z = pk2(s[4 * 33], s[5 * 33]); o.w = pk2(s[6 * 33], s[7 * 33]);
        *(GAS v4u*)(WT + (size_t)(n0 + n) * K + k0 + 8 * c) = o; }
    LDS_WAIT(); asm volatile("" ::: "memory");
}
__device__ __forceinline__ void p0_prologue(LAS unsigned char* lds, int gw, int NGW, int gtid, int NGT, int wave, int lane, const float* x, const float* norm_gain, const float* w_in, const float* w_attn, const float* w_rnn, const float* w_out,
                                            const float* w_uk, const float* w_uv, bf16* WTIN, bf16* WTATTN, bf16* WTRNN, bf16* WTOUT, bf16* WUK, bf16* WUVT, bf16* XB, float* RSTD, float* ROWSS) {
    LAS float* scr = (LAS float*)(lds + RING_OFF + wave * 16384);
    constexpr int I_IN = (D / 64) * (NPAD / 32), I_SQ = (D / 64) * (D / 32);
    for (int it = gw; it < I_IN + 3 * I_SQ; it += NGW) {
        int r = it;
        if (r < I_IN) { p0_transpose_item<true>(w_in, D, IN_W, norm_gain, WTIN, scr, r, NPAD / 32, lane); continue; } r -= I_IN;
        if (r < I_SQ) { p0_transpose_item<false>(w_attn, D, D, nullptr, WTATTN, scr, r, D / 32, lane); continue; } r -= I_SQ;
        if (r < I_SQ) { p0_transpose_item<false>(w_rnn, D, D, nullptr, WTRNN, scr, r, D / 32, lane); continue; } r -= I_SQ;
        p0_transpose_item<false>(w_out, D, D, nullptr, WTOUT, scr, r, D / 32, lane);
    }
    for (int i = gtid; i < NH * DC * HD; i += NGT) {
        WUK[i] = (bf16)f2bf(w_uk[i] * (0.125f * LOG2E));
        const int h = i >> 13, d = (i >> 7) & 63, c = i & 127;
        WUVT[i] = (bf16)f2bf(w_uv[(h * DC + c) * HD + d]);
    }
    for (int m = gw; m < M; m += NGW) {
        const GAS f32x4* xr = (const GAS f32x4*)(x + (size_t)m * D) + lane;
        f32x4 v[4]; float s = 0.f;
#pragma unroll
        for (int j = 0; j < 4; ++j) { v[j] = xr[64 * j]; s += (v[j].x * v[j].x + v[j].y * v[j].y) + (v[j].z * v[j].z + v[j].w * v[j].w); }
        s = wave_sum(s);
        if (lane == 0) { RSTD[m] = 1.0f / sqrtf(s * (1.0f / D) + EPS); ROWSS[m] = 0.f; }
        GAS unsigned long long* o8 = (GAS unsigned long long*)(XB + (size_t)m * D) + lane;
#pragma unroll
        for (int j = 0; j < 4; ++j) o8[64 * j] = (unsigned long long)pk2(v[j].x, v[j].y) | ((unsigned long long)pk2(v[j].z, v[j].w) << 32);
    }
}

__device__ __forceinline__ void p2_norms(int gw, int NGW, int lane, const float* T4, const float* kv_gain, const float* ln_g, const float* ln_b, bf16* CKV, bf16* KIDX, float* WIDX) {
    const bool isc = lane < 32, isk = (lane >= 32 && lane < 48), isw = (lane == 48 || lane == 49);
    f32x4 gn = {0.f, 0.f, 0.f, 0.f}, bs = {0.f, 0.f, 0.f, 0.f};
    if (isc) gn = *(const f32x4*)(kv_gain + 4 * lane);
    if (isk) { gn = *(const f32x4*)(ln_g + 4 * (lane - 32)); bs = *(const f32x4*)(ln_b + 4 * (lane - 32)); }
    for (int m = gw; m < M; m += NGW) {
        const f32x4 v = *(const f32x4*)(T4 + (size_t)m * 256 + 4 * lane);
        const float sq = (v.x * v.x + v.y * v.y) + (v.z * v.z + v.w * v.w), sm = (v.x + v.y) + (v.z + v.w);
        const float css = wave_sum(isc ? sq : 0.f);
        const float kmean = wave_sum(isk ? sm : 0.f) * (1.0f / 64.0f);
        const f32x4 dv = v - kmean;
        const float kvar = wave_sum(isk ? ((dv.x * dv.x + dv.y * dv.y) + (dv.z * dv.z + dv.w * dv.w)) : 0.f) * (1.0f / 64.0f);
        if (isc) { const float r = 1.0f / sqrtf(css * (1.0f / 128.0f) + EPS); const f32x4 y = v * r * gn;
            *(v2u*)(CKV + (size_t)m * 128 + 4 * lane) = (v2u){pk2(y.x, y.y), pk2(y.z, y.w)}; }
        else if (isk) { const float r = 1.0f / sqrtf(kvar + EPS); const f32x4 y = dv * r * gn + bs;
            *(v2u*)(KIDX + (size_t)m * 64 + 4 * (lane - 32)) = (v2u){pk2(y.x, y.y), pk2(y.z, y.w)}; }
        else if (isw) { *(f32x4*)(WIDX + (size_t)m * 8 + 4 * (lane - 48)) = v * 0.35355339059327373f; }
    }
}

__device__ __forceinline__ void p2_rnn(LAS unsigned char* lds, int blk, int G, int tid, const bf16* XRNN, const bf16* GRNN, bf16* AE, const float* conv_w, const float* conv_b,
                                       const float* wa, const float* ba, const float* wx, const float* bx, const float* lam) {
    const int lane = tid & 63, wave = __builtin_amdgcn_readfirstlane(tid >> 6), grp = wave >> 2, q = wave & 3;
    const int n = lane & 31, h = lane >> 5, hi = (n >> 4) & 1, cl = n & 15;
    for (int item0 = 2 * blk; item0 < BATCH * 16; item0 += 2 * G) {
        const int item = item0 + grp, b = item >> 4, g = item & 15;
        bf16x8 Bg[4], Bid;
        { const float* wsrc = (hi ? wx : wa) + g * 4096 + 16 * q + cl;
#pragma unroll
          for (int ks = 0; ks < 4; ++ks) { float t[8];
#pragma unroll
              for (int j = 0; j < 8; ++j) t[j] = wsrc[(16 * ks + 8 * h + j) * 64];
              Bg[ks] = as_bf16x8((v4u){pk2(t[0], t[1]), pk2(t[2], t[3]), pk2(t[4], t[5]), pk2(t[6], t[7])}); }
          unsigned short e[8];
#pragma unroll
          for (int j = 0; j < 8; ++j) e[j] = (cl - 8 * h == j) ? 0x3F80 : 0;
          Bid = as_bf16x8((v4u){(unsigned)e[0] | ((unsigned)e[1] << 16), (unsigned)e[2] | ((unsigned)e[3] << 16), (unsigned)e[4] | ((unsigned)e[5] << 16), (unsigned)e[6] | ((unsigned)e[7] << 16)}); }
        const int ch = 64 * g + 16 * q + cl;
        const float bav = ba[ch], bxv = bx[ch];
        const float sp8 = 8.0f * LOG2E * log1pf(expf(-lam[ch]));
        const int cc0 = 64 * g + 16 * q + 8 * h;
        float cw[4][8], cb[8];
#pragma unroll
        for (int j = 0; j < 8; ++j) { cb[j] = conv_b[cc0 + j];
#pragma unroll
            for (int k = 0; k < 4; ++k) cw[k][j] = conv_w[k * 1024 + cc0 + j]; }
        const bf16* xbase = XRNN + (size_t)b * SEQ * 1024 + cc0;
        const bf16* gbase = GRNN + (size_t)b * SEQ * 1024 + ch;
        bf16* obase = AE + (size_t)b * SEQ * 1024 + ch;
        int rowi[8];
#pragma unroll
        for (int i = 0; i < 8; ++i) { const int ri = i + 8 * hi; rowi[i] = (ri & 3) + 8 * (ri >> 2) + 4 * h; }
        v4u xc_[4]; unsigned short gc_[8];
#pragma unroll
        for (int k = 0; k < 4; ++k) { const int rr = n - 3 + k; xc_[k] = (v4u){0u, 0u, 0u, 0u}; if (rr >= 0) xc_[k] = *(const v4u*)(xbase + (size_t)rr * 1024); }
#pragma unroll
        for (int i = 0; i < 8; ++i) gc_[i] = gbase[(size_t)rowi[i] * 1024];
        float carry = 0.f;
        for (int c = 0; c < SEQ / 32; ++c) {
            const int t0 = 32 * c;
            v4u xn_[4]; unsigned short gn_[8];
            if (c + 1 < SEQ / 32) {
#pragma unroll
                for (int k = 0; k < 4; ++k) xn_[k] = *(const v4u*)(xbase + (size_t)(t0 + 32 + n - 3 + k) * 1024);
#pragma unroll
                for (int i = 0; i < 8; ++i) gn_[i] = gbase[(size_t)(t0 + 32 + rowi[i]) * 1024];
            } else {
#pragma unroll
                for (int k = 0; k < 4; ++k) xn_[k] = xc_[k];
#pragma unroll
                for (int i = 0; i < 8; ++i) gn_[i] = gc_[i];
            }
            float xv[8];
#pragma unroll
            for (int j = 0; j < 8; ++j) xv[j] = cb[j];
#pragma unroll
            for (int k = 0; k < 4; ++k) { const v4u u = xc_[k];
                xv[0] += cw[k][0] * bf_lo(u.x); xv[1] += cw[k][1] * bf_hi(u.x); xv[2] += cw[k][2] * bf_lo(u.y); xv[3] += cw[k][3] * bf_hi(u.y);
                xv[4] += cw[k][4] * bf_lo(u.z); xv[5] += cw[k][5] * bf_hi(u.z); xv[6] += cw[k][6] * bf_lo(u.w); xv[7] += cw[k][7] * bf_hi(u.w); }
            const v4u afrag = (v4u){cvtpk(xv[0], xv[1]), cvtpk(xv[2], xv[3]), cvtpk(xv[4], xv[5]), cvtpk(xv[6], xv[7])};
            LAS unsigned char* fb = lds + L_FRAG + ((grp * 2 + (c & 1)) * 4) * 1024 + lane * 16;
            *(LAS v4u*)(fb + q * 1024) = afrag;
            __syncthreads();
            f32x16 acc, accx;
#pragma unroll
            for (int i = 0; i < 16; ++i) { acc[i] = 0.f; accx[i] = 0.f; }
#pragma unroll
            for (int ks = 0; ks < 4; ++ks) { const v4u a = *(const LAS v4u*)(fb + ks * 1024); acc = mfma32(as_bf16x8(a), Bg[ks], acc); }
            accx = mfma32(as_bf16x8(afrag), Bid, accx);
            float av[8], bv[8];
#pragma unroll
            for (int i = 0; i < 8; ++i) {
                const float send = hi ? acc[i] : acc[8 + i];
                const float recv = __shfl_xor(send, 16);
                const float Rv = hi ? recv : acc[i], Iv = hi ? acc[8 + i] : recv, Xv = hi ? accx[8 + i] : accx[i];
                const float r = sigm(Rv + bav), ig = sigm(Iv + bxv);
                const float a = ex2(-sp8 * r);
                av[i] = a; bv[i] = sqrtf(fmaxf(__builtin_fmaf(-a, a, 1.0f), 0.f)) * (ig * Xv);
            }
            float P0 = av[0] * av[1] * av[2] * av[3], P1 = av[4] * av[5] * av[6] * av[7];
            float H0 = bv[0]; H0 = av[1] * H0 + bv[1]; H0 = av[2] * H0 + bv[2]; H0 = av[3] * H0 + bv[3];
            float H1 = bv[4]; H1 = av[5] * H1 + bv[5]; H1 = av[6] * H1 + bv[6]; H1 = av[7] * H1 + bv[7];
            const float oP0 = __shfl_xor(P0, 32), oH0 = __shfl_xor(H0, 32), oP1 = __shfl_xor(P1, 32), oH1 = __shfl_xor(H1, 32);
            const float sP0 = h ? oP0 : P0, sH0 = h ? oH0 : H0, sP1 = h ? P0 : oP0, sH1 = h ? H0 : oH0;
            const float sP2 = h ? oP1 : P1, sH2 = h ? oH1 : H1, sP3 = h ? P1 : oP1, sH3 = h ? H1 : oH1;
            const float PP = sP0 * sP1 * sP2 * sP3;
            float HH = sH0; HH = sP1 * HH + sH1; HH = sP2 * HH + sH2; HH = sP3 * HH + sH3;
            const float qP = __shfl_xor(PP, 16), qH = __shfl_xor(HH, 16);
            const float st0 = hi ? (qP * carry + qH) : carry;
            const float st1 = sP0 * st0 + sH0, st2 = sP1 * st1 + sH1, st3 = sP2 * st2 + sH2, st4 = sP3 * st3 + sH3;
            carry = hi ? st4 : (qP * st4 + qH);
            float hin0 = h ? st1 : st0, hin1 = h ? st3 : st2;
            float hv[8];
            hv[0] = av[0] * hin0 + bv[0]; hv[1] = av[1] * hv[0] + bv[1]; hv[2] = av[2] * hv[1] + bv[2]; hv[3] = av[3] * hv[2] + bv[3];
            hv[4] = av[4] * hin1 + bv[4]; hv[5] = av[5] * hv[4] + bv[5]; hv[6] = av[6] * hv[5] + bv[6]; hv[7] = av[7] * hv[6] + bv[7];
#pragma unroll
            for (int i = 0; i < 8; ++i) obase[(size_t)(t0 + rowi[i]) * 1024] = (bf16)f2bf(hv[i] * __uint_as_float((unsigned)gc_[i] << 16));
#pragma unroll
            for (int k = 0; k < 4; ++k) xc_[k] = xn_[k];
#pragma unroll
            for (int i = 0; i < 8; ++i) gc_[i] = gn_[i];
        }
        __syncthreads();
    }
}
template <int SHIFT>
__device__ __forceinline__ void radix_pass(const unsigned (&key)[32], int ni, unsigned prefix, unsigned K, LAS unsigned* hist, int lane, unsigned& bin, unsigned& above, unsigned& inbin) {
    *(LAS v4u*)(hist + 4 * lane) = (v4u){0u, 0u, 0u, 0u};
#pragma unroll
    for (int i = 0; i < 32; ++i) if (i < ni) { const unsigned k = key[i]; const bool match = (k != 0u) && ((SHIFT == 16) || ((k >> (SHIFT + 8)) == prefix));
        if (match) __hip_atomic_fetch_add(hist + ((k >> SHIFT) & 255u), 1u, __ATOMIC_RELAXED, __HIP_MEMORY_SCOPE_WORKGROUP); }
    LDS_WAIT(); asm volatile("" ::: "memory");
    const v4u hq = *(const LAS v4u*)(hist + 4 * lane);
    const unsigned s = hq.x + hq.y + hq.z + hq.w;
    unsigned x = s;
#pragma unroll
    for (int d = 1; d < 64; d <<= 1) { const unsigned y = __shfl_down(x, d); if (lane + d < 64) x += y; }
    const unsigned suf = x - s;
    const bool here = (suf < K) && (suf + s >= K);
    unsigned bl, ab, ib, run = suf;
    if (run + hq.w >= K) { bl = 3; ab = run; ib = hq.w; }
    else { run += hq.w; if (run + hq.z >= K) { bl = 2; ab = run; ib = hq.z; }
        else { run += hq.z; if (run + hq.y >= K) { bl = 1; ab = run; ib = hq.y; } else { run += hq.y; bl = 0; ab = run; ib = hq.x; } } }
    const unsigned long long bal = __ballot(here);
    int src = __ffsll((long long)bal) - 1; src = src < 0 ? 0 : src;
    bin = (unsigned)__shfl((int)(4 * lane + bl), src); above = (unsigned)__shfl((int)ab, src); inbin = (unsigned)__shfl((int)ib, src);
    LDS_WAIT(); asm volatile("" ::: "memory");
}
__device__ __forceinline__ void topk_wave(const LAS float* sc, int t, LAS unsigned* hist, LAS unsigned short* sel, int lane) {
    const int ni = (t + 64) >> 6;
    unsigned key[32];
    float m = 0.f;
#pragma unroll
    for (int i = 0; i < 32; ++i) { float v = 0.f; if (i < ni) v = sc[64 * i + lane]; if (64 * i + lane > t) v = 0.f; key[i] = __float_as_uint(v); m = fmaxf(m, fabsf(v)); }
    m = wave_max(m);
    const float scale = m > 0.f ? 4194304.0f / m : 0.f;
#pragma unroll
    for (int i = 0; i < 32; ++i) { const float v = __uint_as_float(key[i]); key[i] = (64 * i + lane <= t) ? (unsigned)((int)rintf(v * scale) + 4194305) : 0u; }
    unsigned b1, a1, c1, b2, a2, c2, b3, a3, c3;
    radix_pass<16>(key, ni, 0u, (unsigned)TOPK, hist, lane, b1, a1, c1);
    radix_pass<8>(key, ni, b1, (unsigned)TOPK - a1, hist, lane, b2, a2, c2);
    radix_pass<0>(key, ni, (b1 << 8) | b2, (unsigned)TOPK - a1 - a2, hist, lane, b3, a3, c3);
    const unsigned T = (b1 << 16) | (b2 << 8) | b3, need = (unsigned)TOPK - a1 - a2 - a3;
    unsigned msel = 0u, mtie = 0u;
#pragma unroll
    for (int i = 0; i < 32; ++i) if (i < ni) { msel |= (key[i] > T ? 1u : 0u) << i; mtie |= (key[i] == T ? 1u : 0u) << i; }
    if (c3 != need) {
        unsigned run = 0u, keep = 0u;
#pragma unroll
        for (int i = 0; i < 32; ++i) if (i < ni) { const bool ti = (mtie >> i) & 1u; const unsigned long long bl = __ballot(ti);
            const unsigned rank = run + (unsigned)__popcll(bl & ((1ull << lane) - 1ull)); if (ti && rank < need) keep |= 1u << i; run += (unsigned)__popcll(bl); }
        mtie = keep;
    }
    msel |= mtie;
    const unsigned cnt = (unsigned)__popc(msel);
    unsigned x = cnt;
#pragma unroll
    for (int d = 1; d < 64; d <<= 1) { const unsigned y = __shfl_up(x, d); if (lane >= d) x += y; }
    unsigned pos = x - cnt;
    while (msel) { const int i = __ffs((int)msel) - 1; msel &= msel - 1u; if (pos < (unsigned)TOPK) sel[pos] = (unsigned short)(64 * i + lane); ++pos; }
}

__device__ __forceinline__ void p3_attn(LAS unsigned char* lds, int blk, int G, int tid, const bf16* Q, const bf16* QIDX, const bf16* KIDX, const float* WIDX, const bf16* CKV, const bf16* WUK, const bf16* WUVT, bf16* GATTN) {
    const int lane = tid & 63, w = __builtin_amdgcn_readfirstlane(tid >> 6), l15 = lane & 15, g4 = lane >> 4;
    const bool flip_ok = (G % 128) == 0;
    LAS unsigned short* selb = (LAS unsigned short*)(lds + L_SEL);
    LAS unsigned* hist = (LAS unsigned*)(lds + L_HIST) + w * 256;
    LAS unsigned char* gb = lds + L_GB + w * 8192;
    const float slope2 = ex2(-0.5f * (float)(l15 + 1)) * LOG2E;
    const int swz = 2 * (l15 & 7);
    for (int k = 0;; ++k) {
        const int L = k * G + blk; if (L >= BATCH * (SEQ / 16)) break;
        const int b = L >> 7; int tt = L & 127; if (flip_ok && (k & 1)) tt = 127 - tt;
        const int t0 = 16 * tt, row0 = b * SEQ + t0;
        if (t0 >= TOPK) {
            bf16x8 Bq[8][2]; const bf16* qp = QIDX + (size_t)(row0 + l15) * 512 + 8 * g4;
#pragma unroll
            for (int j = 0; j < 8; ++j) { Bq[j][0] = *(const bf16x8*)(qp + 64 * j); Bq[j][1] = *(const bf16x8*)(qp + 64 * j + 32); }
            const f32x4 w0 = *(const f32x4*)(WIDX + (size_t)(row0 + l15) * 8), w1 = *(const f32x4*)(WIDX + (size_t)(row0 + l15) * 8 + 4);
            const float wv[8] = {w0.x, w0.y, w0.z, w0.w, w1.x, w1.y, w1.z, w1.w};
            for (int kt = w; kt <= tt; kt += 8) {
                const bf16* kp = KIDX + (size_t)(b * SEQ + 16 * kt + l15) * 64 + 8 * g4;
                const bf16x8 A0 = *(const bf16x8*)kp, A1 = *(const bf16x8*)(kp + 32);
                f32x4 I = {0.f, 0.f, 0.f, 0.f};
#pragma unroll
                for (int j = 0; j < 8; ++j) { f32x4 S = mfma16(A0, Bq[j][0], (f32x4){0.f, 0.f, 0.f, 0.f}); S = mfma16(A1, Bq[j][1], S);
                    I[0] += wv[j] * fmaxf(S[0], 0.f); I[1] += wv[j] * fmaxf(S[1], 0.f); I[2] += wv[j] * fmaxf(S[2], 0.f); I[3] += wv[j] * fmaxf(S[3], 0.f); }
                *(LAS f32x4*)(lds + L_SC + (l15 * SC_STRIDE + 16 * kt + 4 * g4) * 4) = I;
            }
        }
        __syncthreads();
#pragma unroll 1
        for (int tk = 0; tk < 2; ++tk) { const int tok = 2 * w + tk, t = t0 + tok; LAS unsigned short* sel = selb + tok * 256;
            if (t0 < TOPK) { for (int p = lane; p < 256; p += 64) sel[p] = (unsigned short)(p <= t ? p : 0); }
            else topk_wave((const LAS float*)(lds + L_SC) + tok * SC_STRIDE, t, hist, sel, lane);
        }
        __syncthreads();
#pragma unroll 1
        for (int hh = 0; hh < 2; ++hh) { const int hd = 2 * w + hh;
            const bf16* qp = Q + (size_t)(row0 + l15) * 1024 + 64 * hd + 8 * g4; const bf16x8 B0 = *(const bf16x8*)qp, B1 = *(const bf16x8*)(qp + 32);
#pragma unroll
            for (int ct = 0; ct < 8; ++ct) { const bf16* up = WUK + (size_t)(hd * 128 + 16 * ct + l15) * 64 + 8 * g4;
                f32x4 Dv = mfma16(*(const bf16x8*)up, B0, (f32x4){0.f, 0.f, 0.f, 0.f}); Dv = mfma16(*(const bf16x8*)(up + 32), B1, Dv);
                *(LAS v2u*)(lds + L_QL + ((l15 * 16 + hd) * 128 + 16 * ct + 4 * g4) * 2) = (v2u){cvtpk(Dv[0], Dv[1]), cvtpk(Dv[2], Dv[3])}; }
        }
        __syncthreads();
        f32x4 O[2][8];
#pragma unroll
        for (int tk = 0; tk < 2; ++tk) { const int tok = 2 * w + tk, t = t0 + tok; const int nsel = (t + 1 < TOPK) ? t + 1 : TOPK, nch = (nsel + 31) >> 5;
            const LAS unsigned short* sel = selb + tok * 256;
            bf16x8 Bql[4];
#pragma unroll
            for (int ks = 0; ks < 4; ++ks) Bql[ks] = *(const LAS bf16x8*)(lds + L_QL + ((tok * 16 + l15) * 128 + 32 * ks + 8 * g4) * 2);
#pragma unroll
            for (int ct = 0; ct < 8; ++ct) O[tk][ct] = (f32x4){0.f, 0.f, 0.f, 0.f};
            float mrun = -1e30f, ls = 0.f;
            for (int ch = 0; ch < nch; ++ch) {
#pragma unroll
                for (int e = 0; e < 8; ++e) { const int R = 4 * e + g4; const int idx = sel[32 * ch + R]; const int cs = l15 ^ (2 * (R & 7));
                    __builtin_amdgcn_global_load_lds((const unsigned*)(CKV + ((size_t)(b * SEQ + idx)) * 128 + 8 * cs), (LAS unsigned*)(gb + e * 1024), 16, 0, 0); }
                const v2u i0 = *(const LAS v2u*)(sel + 32 * ch + 4 * g4), i1 = *(const LAS v2u*)(sel + 32 * ch + 16 + 4 * g4);
                VM_WAIT();
                f32x4 S0 = {0.f, 0.f, 0.f, 0.f}, S1 = {0.f, 0.f, 0.f, 0.f};
#pragma unroll
                for (int ks = 0; ks < 4; ++ks) { const int so = 16 * ((4 * ks + g4) ^ swz);
                    const bf16x8 a0 = *(const LAS bf16x8*)(gb + l15 * 256 + so), a1 = *(const LAS bf16x8*)(gb + (16 + l15) * 256 + so);
                    S0 = mfma16(a0, Bql[ks], S0); S1 = mfma16(a1, Bql[ks], S1); }
                const int id0[4] = {(int)(i0.x & 0xffffu), (int)(i0.x >> 16), (int)(i0.y & 0xffffu), (int)(i0.y >> 16)}, id1[4] = {(int)(i1.x & 0xffffu), (int)(i1.x >> 16), (int)(i1.y & 0xffffu), (int)(i1.y >> 16)};
                float l0[4], l1[4]; float cm = -INFINITY;
#pragma unroll
                for (int r = 0; r < 4; ++r) { const int p0 = 32 * ch + 4 * g4 + r;
                    l0[r] = (p0 < nsel) ? S0[r] - slope2 * (float)(t - id0[r]) : -INFINITY; l1[r] = (p0 + 16 < nsel) ? S1[r] - slope2 * (float)(t - id1[r]) : -INFINITY;
                    cm = fmaxf(cm, fmaxf(l0[r], l1[r])); }
                cm = fmaxf(cm, __shfl_xor(cm, 16)); cm = fmaxf(cm, __shfl_xor(cm, 32));
                const float mn = fmaxf(mrun, cm), alpha = ex2(mrun - mn); mrun = mn;
                float ps = 0.f;
#pragma unroll
                for (int r = 0; r < 4; ++r) { l0[r] = ex2(l0[r] - mn); l1[r] = ex2(l1[r] - mn); ps += l0[r] + l1[r]; }
                ls = ls * alpha + ps;
                if (__any(alpha != 1.0f)) {
#pragma unroll
                    for (int ct = 0; ct < 8; ++ct) O[tk][ct] = O[tk][ct] * alpha;
                }
                const bf16x8 Pf = as_bf16x8((v4u){cvtpk(l0[0], l0[1]), cvtpk(l0[2], l0[3]), cvtpk(l1[0], l1[1]), cvtpk(l1[2], l1[3])});
                const int q_ = l15 >> 2, pp = l15 & 3, R0 = 4 * g4 + q_;
                LAS unsigned char* tb = gb + R0 * 256 + 8 * (pp & 1);
#pragma unroll
                for (int ct = 0; ct < 8; ++ct) { const int slot = ((2 * ct) ^ (2 * (R0 & 7))) | (pp >> 1);
                    const s16x4 lo = tr_read(tb + 16 * slot), hi = tr_read(tb + 16 * slot + 4096);
                    const bf16x8 A = (bf16x8){lo[0], lo[1], lo[2], lo[3], hi[0], hi[1], hi[2], hi[3]};
                    O[tk][ct] = mfma16(A, Pf, O[tk][ct]); }
            }
            ls += __shfl_xor(ls, 16); ls += __shfl_xor(ls, 32);
            const float inv = 1.0f / ls;
#pragma unroll
            for (int ct = 0; ct < 8; ++ct) O[tk][ct] = O[tk][ct] * inv;
        }
        __syncthreads();
#pragma unroll
        for (int tk = 0; tk < 2; ++tk)
#pragma unroll
            for (int ct = 0; ct < 8; ++ct) *(LAS v2u*)(lds + L_QL + (((2 * w + tk) * 16 + l15) * 128 + 16 * ct + 4 * g4) * 2) = (v2u){cvtpk(O[tk][ct][0], O[tk][ct][1]), cvtpk(O[tk][ct][2], O[tk][ct][3])};
        __syncthreads();
#pragma unroll 1
        for (int hh = 0; hh < 2; ++hh) { const int hd = 2 * w + hh;
            bf16x8 Bo[4];
#pragma unroll
            for (int ks = 0; ks < 4; ++ks) Bo[ks] = *(const LAS bf16x8*)(lds + L_QL + ((l15 * 16 + hd) * 128 + 32 * ks + 8 * g4) * 2);
#pragma unroll
            for (int dt = 0; dt < 4; ++dt) { f32x4 Dv = {0.f, 0.f, 0.f, 0.f}; const bf16* vp = WUVT + (size_t)(hd * 64 + 16 * dt + l15) * 128 + 8 * g4;
#pragma unroll
                for (int ks = 0; ks < 4; ++ks) Dv = mfma16(*(const bf16x8*)(vp + 32 * ks), Bo[ks], Dv);
                bf16* gp = GATTN + (size_t)(row0 + l15) * 1024 + 64 * hd + 16 * dt + 4 * g4; const v2u gg = *(const v2u*)gp;
                *(v2u*)gp = (v2u){cvtpk(Dv[0] * bf_lo(gg.x), Dv[1] * bf_hi(gg.x)), cvtpk(Dv[2] * bf_lo(gg.y), Dv[3] * bf_hi(gg.y))}; }
        }
        __syncthreads();
    }
}
__device__ __forceinline__ void p6_final(int gw, int NGW, int lane, float* Y, const float* ROWSS, const float* fgain) {
    f32x4 gn[4];
#pragma unroll
    for (int j = 0; j < 4; ++j) gn[j] = *(const f32x4*)(fgain + 4 * lane + 256 * j);
    for (int m = gw; m < M; m += NGW) {
        const float rs = 1.0f / sqrtf(ROWSS[m] * (1.0f / D) + EPS);
        GAS f32x4* yr = (GAS f32x4*)(Y + (size_t)m * D) + lane;
#pragma unroll
        for (int j = 0; j < 4; ++j) { const f32x4 v = yr[64 * j]; yr[64 * j] = v * rs * gn[j]; }
    }
}

struct Args { const float* in[20]; float* out; unsigned char* ws; int ph_lo, ph_hi; };
__global__ void __launch_bounds__(NWAVES * 64, 2) hybrid_fwd(Args args) {
    extern __shared__ __attribute__((aligned(16))) unsigned char lds_raw[];
    LAS unsigned char* lds = (LAS unsigned char*)lds_raw;
    volatile LAS unsigned* MISC = (volatile LAS unsigned*)(lds + MISC_OFF);
    const int tid = threadIdx.x, lane = tid & 63, wave = __builtin_amdgcn_readfirstlane(tid >> 6);
    const int G = gridDim.x, bx = blockIdx.x;
    const int vcu = (G % 8 == 0) ? (bx % 8) * (G / 8) + bx / 8 : bx;
    const int gw = vcu * NWAVES + wave, NGW = G * NWAVES, gtid = bx * (NWAVES * 64) + tid, NGT = G * NWAVES * 64;
    unsigned char* ws = args.ws;
    gu32* ctl = (gu32*)(ws + WS_CTL);
    const float* x = args.in[0];
    float* RSTD = (float*)(ws + WS_RSTD); float* ROWSS = (float*)(ws + WS_ROWSS); float* WIDX = (float*)(ws + WS_WIDX);
    bf16 *WTIN = (bf16*)(ws + WS_WTIN), *WTATTN = (bf16*)(ws + WS_WTATTN), *WTRNN = (bf16*)(ws + WS_WTRNN), *WTOUT = (bf16*)(ws + WS_WTOUT), *WUK = (bf16*)(ws + WS_WUK), *WUVT = (bf16*)(ws + WS_WUVT);
    bf16 *CKV = (bf16*)(ws + WS_CKV), *KIDX = (bf16*)(ws + WS_KIDX), *Qb = (bf16*)(ws + WS_Q), *QIDX = (bf16*)(ws + WS_QIDX), *GATTN = (bf16*)(ws + WS_GATTN), *XRNN = (bf16*)(ws + WS_XRNN), *GRNN = (bf16*)(ws + WS_GRNN), *GATES = (bf16*)(ws + WS_GATES);
    float* T4 = (float*)(ws + WS_T4);
    bf16* XB = (bf16*)args.out; bf16* AE = (bf16*)args.out;
    bf16* MX = XRNN; bf16* MIXED = Qb;

    for (int u = tid; u < (LDS_BYTES - LDSCTL_OFF) / 4; u += NWAVES * 64) ((LAS unsigned*)(lds + LDSCTL_OFF))[u] = 0u;
    __syncthreads();
    XcdBarrier bar; bar.bar = (unsigned*)(ctl + CW_BAR); bar.x = 0; bar.st = nullptr;
    if (N_LAUNCHES == 1) bar = xcd_barrier_post((unsigned*)(ctl + CW_BAR), MISC + 8);
#define GRID_BAR() do { if (N_LAUNCHES == 1) xcd_barrier(bar); } while (0)
    const int lo = args.ph_lo, hi = args.ph_hi;
#define IN(k) (lo <= (k) && (k) < hi)
#define BOTH(k) (IN(k) && IN((k) + 1))

    if (IN(0)) {
        p0_prologue(lds, gw, NGW, gtid, NGT, wave, lane, x, args.in[1], args.in[2], args.in[9], args.in[17], args.in[18], args.in[5], args.in[6], WTIN, WTATTN, WTRNN, WTOUT, WUK, WUVT, XB, RSTD, ROWSS);
        if (BOTH(0)) GRID_BAR();
    }
    if (IN(1)) {
        pg8::Gemm g{XB, WTIN, M, NPAD, D}; pg8::StaticOrder S; S.init(M, NPAD, G, bx);
        pg8::EpiIn E{RSTD, args.in[3], Qb, QIDX, GATTN, XRNN, GRNN, GATES, T4};
        pg8::gemm_phase<pg8::EpiIn, pg8::StaticOrder, true, true>(lds + RING_OFF, g, S, E);
        if (BOTH(1)) GRID_BAR();
    }
    if (IN(2)) {
        p2_norms(gw, NGW, lane, T4, args.in[4], args.in[7], args.in[8], CKV, KIDX, WIDX);
        p2_rnn(lds, bx, G, tid, XRNN, GRNN, AE, args.in[10], args.in[11], args.in[12], args.in[13], args.in[14], args.in[15], args.in[16]);
        if (BOTH(2)) GRID_BAR();
    }
    if (IN(3)) {
        { pg8::Gemm g{AE, WTRNN, M, D, D}; pg8::StaticOrder S; S.init(M, D, G, bx);
          pg8::EpiMx E{GATES, MX};
          pg8::gemm_phase<pg8::EpiMx, pg8::StaticOrder, true, true>(lds + RING_OFF, g, S, E); }
        __syncthreads();
        p3_attn(lds, bx, G, tid, Qb, QIDX, KIDX, WIDX, CKV, WUK, WUVT, GATTN);
        if (BOTH(3)) GRID_BAR();
    }
    if (IN(4)) {
        pg8::Gemm g{GATTN, WTATTN, M, D, D}; pg8::StaticOrder S; S.init(M, D, G, bx);
        pg8::EpiMixed E{GATES, MX, MIXED};
        pg8::gemm_phase<pg8::EpiMixed, pg8::StaticOrder, true, true>(lds + RING_OFF, g, S, E);
        if (BOTH(4)) GRID_BAR();
    }
    if (IN(5)) {
        pg8::Gemm g{MIXED, WTOUT, M, D, D}; pg8::StaticOrder S; S.init(M, D, G, bx);
        pg8::EpiOut E{x, args.out, ROWSS};
        pg8::gemm_phase<pg8::EpiOut, pg8::StaticOrder, true, true>(lds + RING_OFF, g, S, E);
        if (BOTH(5)) GRID_BAR();
    }
    if (IN(6)) {
        p6_final(gw, NGW, lane, args.out, ROWSS, args.in[19]);
    }
#undef IN
#undef BOTH
}

extern "C" void kernel_launch(void* const* d_in, const int* in_sizes, int n_in, void* d_out, int out_size, void* d_ws, size_t ws_size, hipStream_t stream) {
    static int grid = 0;
    if (grid == 0) {
        if (n_in != 20 || in_sizes[0] != M * D || out_size != M * D || ws_size < WS_END) {
            fprintf(stderr, "kernel_launch: built for 20 inputs, x/out of %d floats, >= %zu bytes of workspace; got n_in %d, in0 %d, out %d, ws %zu; nothing launched\n", M * D, (size_t)WS_END, n_in, n_in > 0 ? in_sizes[0] : -1, out_size, ws_size); grid = -1; return; }
        int dev = 0, cus = 0, per_cu = 0;
        if (hipGetDevice(&dev) != hipSuccess || hipDeviceGetAttribute(&cus, hipDeviceAttributeMultiprocessorCount, dev) != hipSuccess) { fprintf(stderr, "kernel_launch: device query failed\n"); grid = -1; return; }
        if (hipFuncSetAttribute((const void*)hybrid_fwd, hipFuncAttributeMaxDynamicSharedMemorySize, LDS_BYTES) != hipSuccess) { fprintf(stderr, "kernel_launch: hipFuncSetAttribute failed\n"); grid = -1; return; }
        if (hipOccupancyMaxActiveBlocksPerMultiprocessor(&per_cu, (const void*)hybrid_fwd, NWAVES * 64, LDS_BYTES) != hipSuccess || per_cu < 1) { fprintf(stderr, "kernel_launch: occupancy query reports %d workgroups per CU\n", per_cu); grid = -1; (void)hipGetLastError(); return; }
        (void)hipGetLastError();
        grid = cus;
    }
    if (grid < 0) return;
    if (hipMemsetAsync((char*)d_ws + WS_CTL, 0, CTL_ZERO_BYTES, stream) != hipSuccess) { fprintf(stderr, "kernel_launch: hipMemsetAsync failed\n"); return; }
    Args a{};
    for (int i = 0; i < 20; ++i) a.in[i] = (const float*)d_in[i];
    a.out = (float*)d_out; a.ws = (unsigned char*)d_ws;
    for (int li = 0; li < N_LAUNCHES; ++li) {
        a.ph_lo = (N_LAUNCHES == 1) ? 0 : li; a.ph_hi = (N_LAUNCHES == 1) ? N_PHASES : li + 1;
        hipLaunchKernelGGL(hybrid_fwd, dim3(grid), dim3(NWAVES * 64), LDS_BYTES, stream, a);
        const hipError_t le = hipPeekAtLastError();
        if (le != hipSuccess) { fprintf(stderr, "kernel_launch: launch %d failed: %s\n", li, hipGetErrorName(le)); break; }
    }
}
```
